# Optimizing an MI355X kernel written in HIP

```python
import math
import jax, jax.numpy as jnp
from jax import lax
import numpy as np

D_MODEL = 1024
BATCH = 8
SEQ = 2048
DEPTH = 1

CHUNK = 128
A_GROUPS = 8
A_GROUP_DIM = D_MODEL // A_GROUPS
A_WIDTH = A_GROUPS * A_GROUP_DIM
B_HEADS = 16
B_HEAD_DIM = D_MODEL // B_HEADS
B_WIDTH = B_HEADS * B_HEAD_DIM
DILATED_PATTERNS = ((128, 1), (512, 4), (2048, 16))
N_BRANCHES = 2
D_FF = 4 * D_MODEL
EPS = 1e-6
IN_SPLITS = (A_WIDTH, 2 * A_WIDTH, 2 * A_WIDTH + B_WIDTH, 2 * A_WIDTH + 2 * B_WIDTH,
             2 * A_WIDTH + 3 * B_WIDTH, 2 * A_WIDTH + 3 * B_WIDTH + D_MODEL)
IN_COLS = 2 * A_WIDTH + 3 * B_WIDTH + N_BRANCHES * D_MODEL

kernel_name = "hybrid_gmlp_dilated_alibi_block"


def rms_norm(x, g):
    xf = x.astype(jnp.float32)
    y = xf * lax.rsqrt(jnp.mean(xf * xf, axis=-1, keepdims=True) + EPS)
    return y.astype(x.dtype) * g


def layer_norm(x, g, b):
    xf = x.astype(jnp.float32)
    mu = jnp.mean(xf, axis=-1, keepdims=True)
    var = jnp.mean(jnp.square(xf - mu), axis=-1, keepdims=True)
    return ((xf - mu) * lax.rsqrt(var + EPS)).astype(x.dtype) * g + b


def alibi_slopes(n_heads):
    return jnp.exp2(-8.0 * jnp.arange(1, n_heads + 1, dtype=jnp.float32) / n_heads)


def chunked_spatial_gating(u, v, w_s, b_s, ln_g, ln_b):
    bsz, s, _ = v.shape
    v = layer_norm(v, ln_g, ln_b)
    vc = v.reshape(bsz, s // CHUNK, CHUNK, A_GROUPS, A_GROUP_DIM)
    causal = jnp.tril(jnp.ones((CHUNK, CHUNK), dtype=bool))
    ws = jnp.where(causal[None], w_s, jnp.zeros_like(w_s))
    mixed = jnp.einsum('gts,bcsgd->bctgd', ws, vc) + b_s.T[None, None, :, :, None]
    return u * mixed.reshape(bsz, s, A_WIDTH)


def dilated_window_attention(q, k, v, slopes, window, dilation):
    bsz, s, h, dh = q.shape
    n_back = window // dilation
    blk = n_back
    span = dilation * blk
    sp = -(-s // span) * span
    pad = sp - s
    sub_len = sp // dilation
    nb = sub_len // blk

    def to_sub(t):
        t = jnp.pad(t, ((0, 0), (0, pad), (0, 0), (0, 0)))
        t = jnp.moveaxis(t.reshape(bsz, sub_len, dilation, h, dh), 2, 1)
        return t.reshape(bsz, dilation, nb, blk, h, dh)

    def with_prev(t):
        prev = jnp.pad(t, ((0, 0), (0, 0), (1, 0), (0, 0), (0, 0), (0, 0)))[:, :, :-1]
        return jnp.concatenate([prev, t], axis=3)

    qs = to_sub(q)
    kb = with_prev(to_sub(k))
    vb = with_prev(to_sub(v))
    scores = jnp.einsum('brnqhd,brnkhd->brnhqk', qs, kb).astype(jnp.float32)
    qi = jnp.arange(blk)[:, None]
    ki = jnp.arange(2 * blk)[None, :]
    delta = qi + blk - ki
    blk_idx = jnp.arange(nb)[:, None, None]
    valid = (delta >= 0) & (delta <= n_back) & (blk_idx * blk + qi - delta >= 0)
    bias = -slopes[:, None, None] * (dilation * delta).astype(jnp.float32)
    scores = jnp.where(valid[None, None, :, None], scores + bias[None, None, None], -jnp.inf)
    m = jnp.max(scores, axis=-1, keepdims=True)
    p = jnp.exp(scores - m)
    den = jnp.sum(p, axis=-1)
    out = jnp.einsum('brnhqk,brnkhd->brnqhd', p, vb.astype(jnp.float32))
    out = out / jnp.swapaxes(den, -1, -2)[..., None]
    lse = jnp.swapaxes(m[..., 0] + jnp.log(den), -1, -2)

    def from_sub(t):
        rest = t.shape[4:]
        t = jnp.moveaxis(t.reshape((bsz, dilation, sub_len) + rest), 1, 2)
        return t.reshape((bsz, sp) + rest)[:, :s]

    return from_sub(out).astype(q.dtype), from_sub(lse)


def dilated_attention_mixture(q, k, v):
    slopes = alibi_slopes(B_HEADS)
    outs, lses = [], []
    for window, dilation in DILATED_PATTERNS:
        o, l = dilated_window_attention(q, k, v, slopes, window, dilation)
        outs.append(o)
        lses.append(l)
    w = jax.nn.softmax(jnp.stack(lses, axis=-1), axis=-1)
    o = jnp.stack(outs, axis=-1).astype(jnp.float32)
    return jnp.einsum('bshdp,bshp->bshd', o, w).astype(q.dtype)


def setup_inputs(seed: int = 0) -> dict:
    key = jax.random.key(seed)
    ks = jax.random.split(key, 20)
    f32 = jnp.float32

    def nrm(k, shape, scale):
        return jax.random.normal(k, shape, f32) * scale

    def gain(k, n):
        return 1.0 + nrm(k, (DEPTH, n), 0.02)

    return {
        "x": nrm(ks[0], (BATCH, SEQ, D_MODEL), 1.0),
        "norm_mix_pre": gain(ks[1], D_MODEL),
        "w_in": nrm(ks[2], (DEPTH, D_MODEL, IN_COLS), D_MODEL ** -0.5),
        "b_gate": nrm(ks[3], (DEPTH, N_BRANCHES, D_MODEL), 0.02),
        "ln_v_g": gain(ks[4], A_WIDTH),
        "ln_v_b": nrm(ks[5], (DEPTH, A_WIDTH), 0.02),
        "w_s": nrm(ks[6], (DEPTH, A_GROUPS, CHUNK, CHUNK), 0.5 * CHUNK ** -0.5),
        "b_s": 1.0 + nrm(ks[7], (DEPTH, A_GROUPS, CHUNK), 0.02),
        "w_a_proj": nrm(ks[8], (DEPTH, A_WIDTH, D_MODEL), A_WIDTH ** -0.5),
        "w_b_proj": nrm(ks[9], (DEPTH, B_WIDTH, D_MODEL), B_WIDTH ** -0.5),
        "w_out": nrm(ks[10], (DEPTH, D_MODEL, D_MODEL), D_MODEL ** -0.5),
        "norm_mix_post": gain(ks[11], D_MODEL),
        "norm_ffn_pre": gain(ks[12], D_MODEL),
        "w_ff1": nrm(ks[13], (DEPTH, D_MODEL, D_FF), D_MODEL ** -0.5),
        "w_ff2": nrm(ks[14], (DEPTH, D_FF, D_MODEL), D_FF ** -0.5),
        "norm_ffn_post": gain(ks[15], D_MODEL),
    }


def reference(x, norm_mix_pre, w_in, b_gate, ln_v_g, ln_v_b, w_s, b_s, w_a_proj, w_b_proj,
              w_out, norm_mix_post, norm_ffn_pre, w_ff1, w_ff2, norm_ffn_post):
    bsz, s, _ = x.shape
    q_scale = 1.0 / math.sqrt(B_HEAD_DIM)
    for l in range(DEPTH):
        h = rms_norm(x, norm_mix_pre[l])
        z = h @ w_in[l]
        u_a, v_a, q, k, v_b, g_a, g_b = jnp.split(z, IN_SPLITS, axis=-1)
        y_a = chunked_spatial_gating(jax.nn.gelu(u_a), jax.nn.gelu(v_a), w_s[l], b_s[l],
                                     ln_v_g[l], ln_v_b[l])
        q = q.reshape(bsz, s, B_HEADS, B_HEAD_DIM) * q_scale
        k = k.reshape(bsz, s, B_HEADS, B_HEAD_DIM)
        v_b = v_b.reshape(bsz, s, B_HEADS, B_HEAD_DIM)
        y_b = dilated_attention_mixture(q, k, v_b).reshape(bsz, s, B_WIDTH)
        merged = (jax.nn.sigmoid(g_a + b_gate[l, 0]) * (y_a @ w_a_proj[l])
                  + jax.nn.sigmoid(g_b + b_gate[l, 1]) * (y_b @ w_b_proj[l]))
        x = x + rms_norm(merged @ w_out[l], norm_mix_post[l])
        h = rms_norm(x, norm_ffn_pre[l])
        f = jnp.square(jax.nn.relu(h @ w_ff1[l])) @ w_ff2[l]
        x = x + rms_norm(f, norm_ffn_post[l])
    return x
```

```cpp
#include <hip/hip_runtime.h>
#include <cstdio>
#include <cstdint>
#include <cmath>

typedef unsigned short bf16_t;
constexpr int BATCH = 8, SEQ = 2048, D = 1024, M = BATCH * SEQ, FF = 4096, NIN = 7168, H = 16, HD = 64, CHUNK = 128, G = 8;
constexpr float EPS = 1e-6f;
constexpr size_t MiB = 1u << 20;
constexpr size_t WS_XN = 44 * MiB;
constexpr size_t WS_UQ = 76 * MiB;
constexpr size_t WS_V = 140 * MiB;
constexpr size_t WS_K = 172 * MiB;
constexpr size_t WS_VB = 204 * MiB;
constexpr size_t WS_H = 76 * MiB;
constexpr size_t WS_ST = 40 * MiB;

__device__ __forceinline__ float bf2f(bf16_t b) { return __uint_as_float((unsigned)b << 16); }
__device__ __forceinline__ bf16_t f2bf(float f) { unsigned u = __float_as_uint(f); return (bf16_t)((u + 0x7fffu + ((u >> 16) & 1u)) >> 16); }
__device__ __forceinline__ float gelu_tanh(float x) { const float z = 0.7978845608028654f * (x + 0.044715f * x * x * x); return 0.5f * x * (1.f + tanhf(z)); }
__device__ __forceinline__ float sigmoidf_(float x) { return 1.f / (1.f + expf(-x)); }

__global__ void k_rms_bf16(const float* x, const float* g, bf16_t* out) {
    const int row = blockIdx.x * 4 + (threadIdx.x >> 6), lane = threadIdx.x & 63;
    const float* xr = x + (size_t)row * D; float s = 0.f;
    for (int c = lane; c < D; c += 64) s += xr[c] * xr[c];
    for (int o = 1; o < 64; o <<= 1) s += __shfl_xor(s, o);
    const float r = rsqrtf(s / D + EPS);
    for (int c = lane; c < D; c += 64) out[(size_t)row * D + c] = f2bf(xr[c] * r * g[c]);
}

template <int MODE> __global__ void __launch_bounds__(256) k_gemm(const bf16_t* A, int lda, const float* W, int N, int K, void* out0, void* out1, const float* aux0, const float* aux1,
                                           const bf16_t* A2, const float* W2, const bf16_t* sa, const bf16_t* sb, unsigned char* ws, float* dout) {
    __shared__ float As[16][64 + 1], Bs[16][64 + 1];
    const int tx = threadIdx.x & 15, ty = threadIdx.x >> 4, m0 = blockIdx.y * 64, n0 = blockIdx.x * 64;
    float acc[4][4] = {};
    float acc2[4][4] = {};
    const int npass = (MODE == 1) ? 2 : 1;
    for (int pass = 0; pass < npass; ++pass) {
        const bf16_t* Ap = pass ? A2 : A; const float* Wp = pass ? W2 : W;
        for (int k0 = 0; k0 < K; k0 += 16) {
            for (int i = threadIdx.x; i < 64 * 16; i += 256) { const int r = i >> 4, c = i & 15; As[c][r] = bf2f(Ap[(size_t)(m0 + r) * lda + k0 + c]); }
            for (int i = threadIdx.x; i < 16 * 64; i += 256) { const int r = i >> 6, c = i & 63; Bs[r][c] = Wp[(size_t)(k0 + r) * N + n0 + c]; }
            __syncthreads();
#pragma unroll
            for (int kk = 0; kk < 16; ++kk) {
                float a[4], b[4];
#pragma unroll
                for (int i = 0; i < 4; ++i) { a[i] = As[kk][ty * 4 + i]; b[i] = Bs[kk][tx * 4 + i]; }
#pragma unroll
                for (int i = 0; i < 4; ++i)
#pragma unroll
                    for (int j = 0; j < 4; ++j) { if (pass == 0) acc[i][j] += a[i] * b[j]; else acc2[i][j] += a[i] * b[j]; }
            }
            __syncthreads();
        }
    }
#pragma unroll
    for (int i = 0; i < 4; ++i)
#pragma unroll
        for (int j = 0; j < 4; ++j) {
            const int m = m0 + ty * 4 + i, n = n0 + tx * 4 + j; const float v = acc[i][j];
            if (MODE == 0) {
                const int seg = n >> 10, c = n & 1023;
                if (seg == 0) ((bf16_t*)(ws + WS_UQ))[(size_t)m * 2048 + c] = f2bf(gelu_tanh(v));
                else if (seg == 1) ((bf16_t*)(ws + WS_V))[(size_t)m * D + c] = f2bf(gelu_tanh(v));
                else if (seg == 2) ((bf16_t*)(ws + WS_UQ))[(size_t)m * 2048 + 1024 + c] = f2bf(v * 0.125f);
                else if (seg == 3) ((bf16_t*)(ws + WS_K))[(size_t)m * D + c] = f2bf(v);
                else if (seg == 4) ((bf16_t*)(ws + WS_VB))[(size_t)m * D + c] = f2bf(v);
                else if (seg == 5) ((bf16_t*)dout)[(size_t)m * D + c] = f2bf(sigmoidf_(v + aux0[c]));
                else ((bf16_t*)dout)[(size_t)M * D + (size_t)m * D + c] = f2bf(sigmoidf_(v + aux0[D + c]));
            } else if (MODE == 1) {
                const float ga = bf2f(sa[(size_t)m * D + n]), gb = bf2f(sb[(size_t)m * D + n]);
                ((bf16_t*)out0)[(size_t)m * D + n] = f2bf(ga * v + gb * acc2[i][j]);
            } else if (MODE == 2) {
                ((float*)out0)[(size_t)m * N + n] = v;
            } else {
                const float r = v > 0.f ? v : 0.f; ((bf16_t*)out0)[(size_t)m * N + n] = f2bf(r * r);
            }
        }
}

__global__ void k_lnstats(const bf16_t* v, float* st) {
    const int row = blockIdx.x * 4 + (threadIdx.x >> 6), lane = threadIdx.x & 63;
    float s = 0.f; for (int c = lane; c < D; c += 64) s += bf2f(v[(size_t)row * D + c]);
    for (int o = 1; o < 64; o <<= 1) s += __shfl_xor(s, o);
    const float mu = s / D; float q = 0.f;
    for (int c = lane; c < D; c += 64) { const float d = bf2f(v[(size_t)row * D + c]) - mu; q += d * d; }
    for (int o = 1; o < 64; o <<= 1) q += __shfl_xor(q, o);
    if (lane == 0) { st[row * 2] = mu; st[row * 2 + 1] = rsqrtf(q / D + EPS); }
}
__global__ void k_sgu(bf16_t* uq, const bf16_t* v, const float* st, const float* ws_w, const float* bs, const float* lng, const float* lnb) {
    const int m = blockIdx.x, c = threadIdx.x + blockIdx.y * 256; const int g = c >> 7, t = m & 127, m0 = m - t;
    float acc = 0.f;
    for (int s = 0; s <= t; ++s) { const float vn = (bf2f(v[(size_t)(m0 + s) * D + c]) - st[(m0 + s) * 2]) * st[(m0 + s) * 2 + 1] * lng[c] + lnb[c];
        acc += ws_w[((size_t)g * CHUNK + t) * CHUNK + s] * vn; }
    acc += bs[g * CHUNK + t];
    const size_t o = (size_t)m * 2048 + c; uq[o] = f2bf(bf2f(uq[o]) * acc);
}
__global__ void __launch_bounds__(64) k_attn(bf16_t* uq, const bf16_t* kk, const bf16_t* vv) {
    const int idx = blockIdx.x * blockDim.x + threadIdx.x; const int h = idx & 15, m = idx >> 4, t = m & (SEQ - 1), b0 = m - t;
    float q[64], o[64];
#pragma unroll
    for (int d = 0; d < 64; ++d) { q[d] = bf2f(uq[(size_t)m * 2048 + 1024 + h * 64 + d]); o[d] = 0.f; }
    const float slope = exp2f(-0.5f * (float)(h + 1));
    float mx = -INFINITY, l = 0.f;
    for (int p = 0; p < 3; ++p) { const int dil = p == 0 ? 1 : (p == 1 ? 4 : 16);
        for (int j = 0; j <= 128; ++j) { const int tk = t - j * dil; if (tk < 0) break;
            const bf16_t* kr = kk + (size_t)(b0 + tk) * D + h * 64; float s = 0.f;
#pragma unroll
            for (int d = 0; d < 64; ++d) s += q[d] * bf2f(kr[d]);
            s -= slope * (float)(j * dil);
            const float mn = fmaxf(mx, s), a = expf(mx - mn), pw = expf(s - mn); mx = mn; l = l * a + pw;
            const bf16_t* vr = vv + (size_t)(b0 + tk) * D + h * 64;
#pragma unroll
            for (int d = 0; d < 64; ++d) o[d] = o[d] * a + pw * bf2f(vr[d]);
        } }
    const float inv = 1.f / l;
#pragma unroll
    for (int d = 0; d < 64; ++d) uq[(size_t)m * 2048 + 1024 + h * 64 + d] = f2bf(o[d] * inv);
}
__global__ void k_res_rms(const float* base, const float* y, const float* g, float* out, const float* g3, bf16_t* xn2) {
    const int row = blockIdx.x * 4 + (threadIdx.x >> 6), lane = threadIdx.x & 63;
    float s = 0.f; for (int c = lane; c < D; c += 64) { const float v = y[(size_t)row * D + c]; s += v * v; }
    for (int o = 1; o < 64; o <<= 1) s += __shfl_xor(s, o);
    const float r = rsqrtf(s / D + EPS); float s2 = 0.f;
    for (int c = lane; c < D; c += 64) { const float v = base[(size_t)row * D + c] + y[(size_t)row * D + c] * r * g[c]; out[(size_t)row * D + c] = v; s2 += v * v; }
    if (xn2) { for (int o = 1; o < 64; o <<= 1) s2 += __shfl_xor(s2, o);
        const float r2 = rsqrtf(s2 / D + EPS);
        for (int c = lane; c < D; c += 64) xn2[(size_t)row * D + c] = f2bf(out[(size_t)row * D + c] * r2 * g3[c]); }
}

extern "C" void kernel_launch(void* const* d_in, const int* in_sizes, int n_in, void* d_out, int out_size, void* d_ws, size_t ws_size, hipStream_t stream) {
    const float* x = (const float*)d_in[0]; const float* g1 = (const float*)d_in[1]; const float* w_in = (const float*)d_in[2]; const float* b_gate = (const float*)d_in[3];
    const float* lng = (const float*)d_in[4]; const float* lnb = (const float*)d_in[5]; const float* w_s = (const float*)d_in[6]; const float* b_s = (const float*)d_in[7];
    const float* w_a = (const float*)d_in[8]; const float* w_b = (const float*)d_in[9]; const float* w_out = (const float*)d_in[10]; const float* g2 = (const float*)d_in[11];
    const float* g3 = (const float*)d_in[12]; const float* w1 = (const float*)d_in[13]; const float* w2 = (const float*)d_in[14]; const float* g4 = (const float*)d_in[15];
    unsigned char* ws = (unsigned char*)d_ws; float* out = (float*)d_out;
    bf16_t* XN = (bf16_t*)(ws + WS_XN); bf16_t* UQ = (bf16_t*)(ws + WS_UQ); bf16_t* V = (bf16_t*)(ws + WS_V); bf16_t* K = (bf16_t*)(ws + WS_K); bf16_t* VB = (bf16_t*)(ws + WS_VB);
    bf16_t* HB = (bf16_t*)(ws + WS_H); float* ST = (float*)(ws + WS_ST); bf16_t* SA = (bf16_t*)d_out; bf16_t* SB = SA + (size_t)M * D;
    float* Y = (float*)(ws + 140 * MiB);
    k_rms_bf16<<<M / 4, 256, 0, stream>>>(x, g1, XN);
    k_gemm<0><<<dim3(NIN / 64, M / 64), 256, 0, stream>>>(XN, D, w_in, NIN, D, nullptr, nullptr, b_gate, nullptr, nullptr, nullptr, nullptr, nullptr, ws, out);
    k_lnstats<<<M / 4, 256, 0, stream>>>(V, ST);
    k_sgu<<<dim3(M, 4), 256, 0, stream>>>(UQ, V, ST, w_s, b_s, lng, lnb);
    k_attn<<<M * H / 64, 64, 0, stream>>>(UQ, K, VB);
    k_gemm<1><<<dim3(D / 64, M / 64), 256, 0, stream>>>(UQ, 2048, w_a, D, D, XN, nullptr, nullptr, nullptr, UQ + 1024, w_b, SA, SB, ws, out);
    k_gemm<2><<<dim3(D / 64, M / 64), 256, 0, stream>>>(XN, D, w_out, D, D, Y, nullptr, nullptr, nullptr, nullptr, nullptr, nullptr, nullptr, ws, out);
    k_res_rms<<<M / 4, 256, 0, stream>>>(x, Y, g2, out, g3, VB);
    k_gemm<3><<<dim3(FF / 64, M / 64), 256, 0, stream>>>(VB, D, w1, FF, D, HB, nullptr, nullptr, nullptr, nullptr, nullptr, nullptr, nullptr, ws, out);
    float* F = (float*)(ws + 4 * MiB);
    k_gemm<2><<<dim3(D / 64, M / 64), 256, 0, stream>>>(HB, FF, w2, D, FF, F, nullptr, nullptr, nullptr, nullptr, nullptr, nullptr, nullptr, ws, out);
    k_res_rms<<<M / 4, 256, 0, stream>>>(out, F, g4, out, nullptr, nullptr);
}
```
